# Optimizing an MI355X kernel written in HIP

```python
import jax, jax.numpy as jnp
from jax import lax
import numpy as np

D_MODEL = 2048
BATCH = 1
SEQ = 8192
DEPTH = 4

D_MIX = D_MODEL
POOL_WIDTH = D_MIX // 4
POOL_WINDOWS = (2, 4, 8, 16)
POOL_GROUP = POOL_WIDTH // len(POOL_WINDOWS)
CONV_WIDTH = D_MIX // 4
CONV_KERNEL = 31
CONV_PAD = CONV_KERNEL // 2
LRU_WIDTH = D_MIX // 2
LRU_HEADS = 8
LRU_HEAD_DIM = LRU_WIDTH // LRU_HEADS
LRU_CONV = 4
LRU_C = 8.0
D_IN = POOL_WIDTH + 2 * CONV_WIDTH + 2 * LRU_WIDTH
D_FF = 5632
RMS_EPS = 1e-6
LN_EPS = 1e-5

kernel_name = "bidir_hybrid_pool_conv_rglru_macaron"


def rmsnorm(x, g):
    xf = x.astype(jnp.float32)
    y = xf * lax.rsqrt(jnp.mean(xf * xf, axis=-1, keepdims=True) + RMS_EPS)
    return (y * g.astype(jnp.float32)).astype(x.dtype)


def swiglu(x, w_gate, w_up, w_down):
    return (jax.nn.silu(x @ w_gate) * (x @ w_up)) @ w_down


def depthwise_conv(x, w, pad_left, pad_right):
    c = x.shape[-1]
    return lax.conv_general_dilated(
        x, w[:, None, :].astype(x.dtype), window_strides=(1,),
        padding=[(pad_left, pad_right)],
        dimension_numbers=("NWC", "WIO", "NWC"), feature_group_count=c)


def pool_mixer(u, w, scale):
    b, s, _ = u.shape
    uf = u.astype(jnp.float32)
    cs = jnp.pad(jnp.cumsum(uf, axis=1), ((0, 0), (1, 0), (0, 0)))
    t = jnp.arange(s)
    outs = []
    for g, win in enumerate(POOL_WINDOWS):
        lo = jnp.clip(t - win // 2, 0, s)
        hi = jnp.clip(t + win // 2, 0, s)
        csg = cs[..., g * POOL_GROUP:(g + 1) * POOL_GROUP]
        ssum = jnp.take(csg, hi, axis=1) - jnp.take(csg, lo, axis=1)
        cnt = (hi - lo).astype(jnp.float32)[None, :, None]
        outs.append(ssum / cnt)
    pooled = (jnp.concatenate(outs, axis=-1) - uf).astype(u.dtype)
    pooled = pooled.reshape(b, s, len(POOL_WINDOWS), POOL_GROUP)
    mixed = jnp.einsum("bsgi,gij->bsgj", pooled, w).reshape(b, s, POOL_WIDTH)
    return mixed * scale


def conv_module(u, dw_w, dw_b, ln_g, ln_b):
    v, gate = jnp.split(u, 2, axis=-1)
    z = v * jax.nn.sigmoid(gate)
    z = depthwise_conv(z, dw_w, CONV_PAD, CONV_PAD) + dw_b
    zf = z.astype(jnp.float32)
    mu = jnp.mean(zf, axis=-1, keepdims=True)
    var = jnp.mean(jnp.square(zf - mu), axis=-1, keepdims=True)
    zn = ((zf - mu) * lax.rsqrt(var + LN_EPS)).astype(z.dtype) * ln_g + ln_b
    return jax.nn.silu(zn)


def _linear_recurrence(c1, c2):
    a1, b1 = c1
    a2, b2 = c2
    return a1 * a2, a2 * b1 + b2


def rglru_direction(x, conv_w, conv_b, w_a, b_a, w_x, b_x, lam):
    b, s, c = x.shape
    xc = depthwise_conv(x, conv_w, LRU_CONV - 1, 0) + conv_b
    xh = xc.reshape(b, s, LRU_HEADS, LRU_HEAD_DIM)
    r = jax.nn.sigmoid(jnp.einsum("bshi,hij->bshj", xh, w_a).reshape(b, s, c) + b_a)
    i = jax.nn.sigmoid(jnp.einsum("bshi,hij->bshj", xh, w_x).reshape(b, s, c) + b_x)
    log_a = -LRU_C * r.astype(jnp.float32) * jax.nn.softplus(-lam.astype(jnp.float32))
    a = jnp.exp(log_a)
    mult = jnp.sqrt(-jnp.expm1(2.0 * log_a))
    bterm = mult * (i * xc).astype(jnp.float32)
    _, h = lax.associative_scan(_linear_recurrence, (a, bterm), axis=1)
    return h.astype(x.dtype)


def rglru_mixer(u, conv_w, conv_b, w_a, b_a, w_x, b_x, lam):
    gate = jax.nn.gelu(u[..., :LRU_WIDTH])
    xr = u[..., LRU_WIDTH:]
    h_fwd = rglru_direction(xr, conv_w[0], conv_b[0], w_a[0], b_a[0], w_x[0], b_x[0], lam[0])
    h_bwd = rglru_direction(xr[:, ::-1], conv_w[1], conv_b[1], w_a[1], b_a[1], w_x[1], b_x[1], lam[1])[:, ::-1]
    return (h_fwd + h_bwd) * gate


def setup_inputs(seed: int = 0) -> dict:
    key = jax.random.key(seed)
    ks = jax.random.split(key, 32)
    L = DEPTH
    f32 = jnp.float32

    def nrm(k, shape, fan_in):
        return jax.random.normal(k, shape, f32) * (fan_in ** -0.5)

    def gain(k, shape):
        return 1.0 + 0.1 * jax.random.normal(k, shape, f32)

    def bias(k, shape):
        return 0.02 * jax.random.normal(k, shape, f32)

    a8 = jax.random.uniform(ks[31], (L, 2, LRU_WIDTH), f32, minval=0.9, maxval=0.999)
    a_base = a8 ** (1.0 / LRU_C)
    lru_lambda = jnp.log(a_base) - jnp.log1p(-a_base)

    return {
        "x": jax.random.normal(ks[0], (BATCH, SEQ, D_MODEL), f32),
        "norm_ffn1": gain(ks[1], (L, D_MODEL)),
        "ffn1_w_gate": nrm(ks[2], (L, D_MODEL, D_FF), D_MODEL),
        "ffn1_w_up": nrm(ks[3], (L, D_MODEL, D_FF), D_MODEL),
        "ffn1_w_down": nrm(ks[4], (L, D_FF, D_MODEL), D_FF),
        "norm_mix": gain(ks[5], (L, D_MODEL)),
        "w_in": nrm(ks[6], (L, D_MODEL, D_IN), D_MODEL),
        "pool_w": nrm(ks[7], (L, len(POOL_WINDOWS), POOL_GROUP, POOL_GROUP), POOL_GROUP),
        "pool_scale": gain(ks[8], (L, POOL_WIDTH)),
        "conv_dw_w": nrm(ks[9], (L, CONV_KERNEL, CONV_WIDTH), CONV_KERNEL),
        "conv_dw_b": bias(ks[10], (L, CONV_WIDTH)),
        "conv_ln_g": gain(ks[11], (L, CONV_WIDTH)),
        "conv_ln_b": bias(ks[12], (L, CONV_WIDTH)),
        "lru_conv_w": nrm(ks[13], (L, 2, LRU_CONV, LRU_WIDTH), LRU_CONV),
        "lru_conv_b": bias(ks[14], (L, 2, LRU_WIDTH)),
        "lru_w_a": nrm(ks[15], (L, 2, LRU_HEADS, LRU_HEAD_DIM, LRU_HEAD_DIM), LRU_HEAD_DIM),
        "lru_b_a": bias(ks[16], (L, 2, LRU_WIDTH)),
        "lru_w_x": nrm(ks[17], (L, 2, LRU_HEADS, LRU_HEAD_DIM, LRU_HEAD_DIM), LRU_HEAD_DIM),
        "lru_b_x": bias(ks[18], (L, 2, LRU_WIDTH)),
        "lru_lambda": lru_lambda,
        "w_out": nrm(ks[19], (L, D_MIX, D_MODEL), D_MIX),
        "norm_ffn2": gain(ks[20], (L, D_MODEL)),
        "ffn2_w_gate": nrm(ks[21], (L, D_MODEL, D_FF), D_MODEL),
        "ffn2_w_up": nrm(ks[22], (L, D_MODEL, D_FF), D_MODEL),
        "ffn2_w_down": nrm(ks[23], (L, D_FF, D_MODEL), D_FF),
        "norm_final": gain(ks[24], (D_MODEL,)),
    }


def reference(x, norm_ffn1, ffn1_w_gate, ffn1_w_up, ffn1_w_down, norm_mix, w_in,
              pool_w, pool_scale, conv_dw_w, conv_dw_b, conv_ln_g, conv_ln_b,
              lru_conv_w, lru_conv_b, lru_w_a, lru_b_a, lru_w_x, lru_b_x, lru_lambda,
              w_out, norm_ffn2, ffn2_w_gate, ffn2_w_up, ffn2_w_down, norm_final):
    split_conv = POOL_WIDTH
    split_lru = POOL_WIDTH + 2 * CONV_WIDTH
    for l in range(DEPTH):
        h = rmsnorm(x, norm_ffn1[l])
        x = x + 0.5 * swiglu(h, ffn1_w_gate[l], ffn1_w_up[l], ffn1_w_down[l])

        h = rmsnorm(x, norm_mix[l])
        u = h @ w_in[l]
        u_pool = u[..., :split_conv]
        u_conv = u[..., split_conv:split_lru]
        u_lru = u[..., split_lru:]
        y_pool = pool_mixer(u_pool, pool_w[l], pool_scale[l])
        y_conv = conv_module(u_conv, conv_dw_w[l], conv_dw_b[l], conv_ln_g[l], conv_ln_b[l])
        y_lru = rglru_mixer(u_lru, lru_conv_w[l], lru_conv_b[l], lru_w_a[l], lru_b_a[l],
                            lru_w_x[l], lru_b_x[l], lru_lambda[l])
        y = jnp.concatenate([y_pool, y_conv, y_lru], axis=-1)
        x = x + y @ w_out[l]

        h = rmsnorm(x, norm_ffn2[l])
        x = x + 0.5 * swiglu(h, ffn2_w_gate[l], ffn2_w_up[l], ffn2_w_down[l])
    return rmsnorm(x, norm_final)
```

```cpp
#include <hip/hip_runtime.h>
#include <cstdio>
#include <cstdint>
namespace pg8 {
#define PG8_LAS __attribute__((address_space(3)))
typedef unsigned short bf16_t;
typedef short bf16x8 __attribute__((ext_vector_type(8)));
typedef float f32x4 __attribute__((ext_vector_type(4)));
typedef unsigned u32x4 __attribute__((ext_vector_type(4)));
constexpr int BM = 256, BK = 64, HALF = 128, HTB = HALF * BK * 2  , STAGE_BYTES = 8 * HTB, NXCD = 8, WGM = 8;

__host__ __device__ __forceinline__ int lds_byte(int r, int c) { const int st = (r >> 4) * 2 + (c >> 5), rr = r & 15, cc = c & 31, ob = rr * 64 + cc * 2; return st * 1024 + (ob ^ (((ob >> 9) & 1) << 5)); }
__host__ __device__ __forceinline__ void stage_rc(int b, int& R, int& C) { const int st = b / 1024, sb = b % 1024, swz = sb ^ (((sb >> 9) & 1) << 5); R = (st >> 1) * 16 + swz / 64; C = (st & 1) * 32 + (swz % 64) / 2; }
__host__ __device__ __forceinline__ int perm32(int rho) { const int n = rho >> 4, i = rho & 15; return 8 * (i >> 2) + 4 * n + (i & 3); }

struct Unit { int pm, pn; };
struct Gemm { const bf16_t* A; const bf16_t* Bt; int M, N, K; };

struct StaticOrder {
    int nM, nN, nwg, G, c;
    __host__ __device__ void init(int M, int N, int G_, int c_) { nM = M / BM; nN = N / BM; nwg = nM * nN; G = G_; c = c_; }
    __host__ __device__ bool next(int i, Unit& u) const {
        const long L = (long)i * G + c; if (L >= nwg) return false;
        int wgid = (int)L; { const int q = nwg / NXCD, r = nwg % NXCD, xcd = wgid % NXCD, off = wgid / NXCD; wgid = (xcd < r ? xcd * (q + 1) : r * (q + 1) + (xcd - r) * q) + off; }
        const int nig = WGM * nN, gid = wgid / nig, fm = gid * WGM, gsz = (nM - fm) < WGM ? (nM - fm) : WGM;
        u.pm = fm + ((wgid % nig) % gsz); u.pn = (wgid % nig) / gsz; return true;
    }
    __device__ __forceinline__ void a_ready(const Unit&) const {}
    __device__ __forceinline__ void done(const Unit&) const {}
};

#define PG8_GAS __attribute__((address_space(1)))
__device__ __forceinline__ unsigned cvt_pk_bf16(float lo, float hi) { unsigned r; asm volatile("v_cvt_pk_bf16_f32 %0, %1, %2" : "=v"(r) : "v"(lo), "v"(hi)); return r; }
constexpr float RMS_EPS = 1e-6f;
constexpr int XD = 2048;
__device__ __forceinline__ float row_rstd(const float* ssp, int r) {
    const f32x4 s0 = *(const PG8_GAS f32x4*)(ssp + (size_t)r * 8), s1 = *(const PG8_GAS f32x4*)(ssp + (size_t)r * 8 + 4);
    const float ss = ((s0[0] + s0[1]) + (s0[2] + s0[3])) + ((s1[0] + s1[1]) + (s1[2] + s1[3]));
    return rsqrtf(ss * (1.0f / (float)XD) + RMS_EPS);
}
__device__ __forceinline__ float silu_f(float g) { return g * __builtin_amdgcn_rcpf(1.0f + __expf(-g)); }

struct EpiSwiglu {
    static constexpr bool PERM = true, AFTER_DRAIN = false;
    bf16_t* O; int ldc; const float* ssp; const PG8_LAS float* rs_tab; int pm0;
    __device__ __forceinline__ void operator()(const f32x4 (&acc)[2][2][4][2], const Unit& u, int wr, int wc, int fr, int fq) const {
        const int row0 = u.pm * BM + wr * 64 + fr, col0 = u.pn * HALF + wc * 32 + 8 * fq;
        float rsv[2][4];
        if (u.pm == pm0) {
#pragma unroll
            for (int ai = 0; ai < 2; ++ai)
#pragma unroll
                for (int m = 0; m < 4; ++m) rsv[ai][m] = rs_tab[wr * 64 + fr + ai * HALF + m * 16];
        } else {
#pragma unroll
            for (int ai = 0; ai < 2; ++ai)
#pragma unroll
                for (int m = 0; m < 4; ++m) rsv[ai][m] = row_rstd(ssp, row0 + ai * HALF + m * 16);
        }
#pragma unroll
        for (int ai = 0; ai < 2; ++ai)
#pragma unroll
            for (int m = 0; m < 4; ++m) { const int r = row0 + ai * HALF + m * 16; const float rs = rsv[ai][m];
                typedef float f32x2 __attribute__((ext_vector_type(2)));
                const float nrs = rs * -1.4426950408889634f, rs2 = rs * rs;
                f32x4 v0, v1;
#pragma unroll
                for (int n = 0; n < 2; ++n)
#pragma unroll
                    for (int h = 0; h < 2; ++h) { const f32x2 g = (f32x2){acc[ai][0][m][n][2 * h], acc[ai][0][m][n][2 * h + 1]}, uu = (f32x2){acc[ai][1][m][n][2 * h], acc[ai][1][m][n][2 * h + 1]};
                        const f32x2 t = g * nrs; f32x2 e; e.x = __builtin_amdgcn_exp2f(t.x); e.y = __builtin_amdgcn_exp2f(t.y);
                        const f32x2 d = e + 1.0f; f32x2 q; q.x = __builtin_amdgcn_rcpf(d.x); q.y = __builtin_amdgcn_rcpf(d.y);
                        const f32x2 o = ((g * uu) * rs2) * q;
                        if (n == 0) { v0[2 * h] = o.x; v0[2 * h + 1] = o.y; } else { v1[2 * h] = o.x; v1[2 * h + 1] = o.y; } }
                u32x4 w; w.x = cvt_pk_bf16(v0[0], v0[1]); w.y = cvt_pk_bf16(v0[2], v0[3]); w.z = cvt_pk_bf16(v1[0], v1[1]); w.w = cvt_pk_bf16(v1[2], v1[3]);
                *(PG8_GAS u32x4*)(O + (size_t)r * ldc + col0) = w; }
    }
};
struct EpiScaleBf16 {
    static constexpr bool PERM = true, AFTER_DRAIN = false;
    bf16_t* O; int ldc; const float* ssp; const PG8_LAS float* rs_tab; int pm0;
    __device__ __forceinline__ void operator()(const f32x4 (&acc)[2][2][4][2], const Unit& u, int wr, int wc, int fr, int fq) const {
        const int row0 = u.pm * BM + wr * 64 + fr, col0 = u.pn * BM + wc * 32 + 8 * fq;
        float rsv[2][4];
        if (u.pm == pm0) {
#pragma unroll
            for (int ai = 0; ai < 2; ++ai)
#pragma unroll
                for (int m = 0; m < 4; ++m) rsv[ai][m] = rs_tab[wr * 64 + fr + ai * HALF + m * 16];
        } else {
#pragma unroll
            for (int ai = 0; ai < 2; ++ai)
#pragma unroll
                for (int m = 0; m < 4; ++m) rsv[ai][m] = row_rstd(ssp, row0 + ai * HALF + m * 16);
        }
#pragma unroll
        for (int ai = 0; ai < 2; ++ai)
#pragma unroll
            for (int m = 0; m < 4; ++m) { const int r = row0 + ai * HALF + m * 16; const float rs = rsv[ai][m];
#pragma unroll
                for (int bj = 0; bj < 2; ++bj) { const f32x4 v0 = acc[ai][bj][m][0] * rs, v1 = acc[ai][bj][m][1] * rs;
                    u32x4 w; w.x = cvt_pk_bf16(v0[0], v0[1]); w.y = cvt_pk_bf16(v0[2], v0[3]); w.z = cvt_pk_bf16(v1[0], v1[1]); w.w = cvt_pk_bf16(v1[2], v1[3]);
                    *(PG8_GAS u32x4*)(O + (size_t)r * ldc + col0 + bj * HALF) = w; } }
    }
};
__device__ __forceinline__ float bf_lo(unsigned w) { return __uint_as_float(w << 16); }
__device__ __forceinline__ float bf_hi(unsigned w) { return __uint_as_float(w & 0xffff0000u); }
struct EpiResid {
    static constexpr bool PERM = true, AFTER_DRAIN = true;
    bf16_t* XB; float* ssp; float alpha;
    __device__ __forceinline__ void fused(f32x4 (&acc)[2][2][4][2], const Unit& u, int wr, int wc, int fr, int fq, PG8_LAS unsigned char* lds, int wid, int lane) const {
        PG8_LAS float* P = (PG8_LAS float*)lds;
#pragma unroll
        for (int ai = 0; ai < 2; ++ai)
#pragma unroll
            for (int m = 0; m < 4; ++m) { const int rloc = ai * HALF + wr * 64 + m * 16 + fr; const size_t off = (size_t)(u.pm * BM + rloc) * XD + u.pn * BM + wc * 32 + 8 * fq;
                float ss = 0.f;
#pragma unroll
                for (int bj = 0; bj < 2; ++bj) { const u32x4 hv = *(const PG8_GAS u32x4*)(XB + off + bj * HALF);
                    f32x4 x0, x1;
                    x0[0] = bf_lo(hv.x); x0[1] = bf_hi(hv.x); x0[2] = bf_lo(hv.y); x0[3] = bf_hi(hv.y); x1[0] = bf_lo(hv.z); x1[1] = bf_hi(hv.z); x1[2] = bf_lo(hv.w); x1[3] = bf_hi(hv.w);
                    x0 = x0 + acc[ai][bj][m][0] * alpha; x1 = x1 + acc[ai][bj][m][1] * alpha;
                    u32x4 w; w.x = cvt_pk_bf16(x0[0], x0[1]); w.y = cvt_pk_bf16(x0[2], x0[3]); w.z = cvt_pk_bf16(x1[0], x1[1]); w.w = cvt_pk_bf16(x1[2], x1[3]);
                    *(PG8_GAS u32x4*)(XB + off + bj * HALF) = w;
                    ss += ((x0[0] * x0[0] + x0[1] * x0[1]) + (x0[2] * x0[2] + x0[3] * x0[3])) + ((x1[0] * x1[0] + x1[1] * x1[1]) + (x1[2] * x1[2] + x1[3] * x1[3])); }
                ss += __shfl_xor(ss, 16); ss += __shfl_xor(ss, 32);
                if (fq == 0) P[rloc * 4 + wc] = ss;
                if (m == 3) asm volatile("" ::: "memory"); }
        asm volatile("s_waitcnt lgkmcnt(0)" ::: "memory"); __builtin_amdgcn_s_barrier(); asm volatile("" ::: "memory");
        const int t = wid * 64 + lane;
        if (t < 256) ssp[(size_t)(u.pm * BM + t) * 8 + u.pn] = (P[t * 4 + 0] + P[t * 4 + 1]) + (P[t * 4 + 2] + P[t * 4 + 3]);
    }
};

template <class Epi, class Sched, bool ALIGN_EPI = false, bool SP2 = false>
__device__ __forceinline__ void gemm_phase(PG8_LAS unsigned char* lds, const Gemm g, const Sched& S, const Epi& E) {
    int tid_ = threadIdx.x; asm volatile("" : "+v"(tid_));
    const int tid = tid_, wid = __builtin_amdgcn_readfirstlane(tid >> 6), lane = tid & 63, wr = wid >> 2, wc = wid & 3, fr = lane & 15, fq = lane >> 4;
    const int K = g.K, nt = K / BK;
    unsigned voffA[2], voffB[2];
#pragma unroll
    for (int i = 0; i < 2; ++i) { int R, C; stage_rc(tid * 16 + i * 8192, R, C); const int Rb = Epi::PERM ? ((R & ~31) + perm32(R & 31)) : R;
        voffA[i] = (unsigned)(R * K + C) * 2u; voffB[i] = (unsigned)(Rb * K + C) * 2u; }
    const size_t kstep = (size_t)(BK * 2);
    const size_t hstep = (size_t)HALF * K * 2;
    const size_t tstep = 2 * hstep;
    const unsigned ldsw = (unsigned)wid * 1024u;
    const int aoff = lds_byte(wr * 64 + fr, fq * 8), boff = lds_byte(wc * 32 + fr, fq * 8);
#define PG8_SA(b, h) (((b) * 2 + (h)) * HTB)
#define PG8_SB(b, h) ((4 + (b) * 2 + (h)) * HTB)
#define PG8_STAGE(bufoff, gbase, voff) do { _Pragma("unroll") for (int _i = 0; _i < 2; ++_i) \
        __builtin_amdgcn_global_load_lds((const unsigned*)((const char*)(gbase) + (voff)[_i]), (PG8_LAS unsigned*)(lds + (bufoff) + ldsw + _i * 8192), 16, 0, 0); } while (0)
#define PG8_LDA(dst, b, h) do { _Pragma("unroll") for (int m = 0; m < 4; ++m) _Pragma("unroll") for (int k = 0; k < 2; ++k) dst[m][k] = *(const PG8_LAS bf16x8*)(lds + PG8_SA(b, h) + aoff + m * 2048 + k * 1024); } while (0)
#define PG8_LDB(dst, b, h) do { _Pragma("unroll") for (int n = 0; n < 2; ++n) _Pragma("unroll") for (int k = 0; k < 2; ++k) dst[n][k] = *(const PG8_LAS bf16x8*)(lds + PG8_SB(b, h) + boff + n * 2048 + k * 1024); } while (0)
#define PG8_MMA(ai, bj, At, Bt) do { __builtin_amdgcn_s_setprio(1); _Pragma("unroll") for (int m = 0; m < 4; ++m) _Pragma("unroll") for (int n = 0; n < 2; ++n) _Pragma("unroll") for (int k = 0; k < 2; ++k) \
        acc[ai][bj][m][n] = __builtin_amdgcn_mfma_f32_16x16x32_bf16(Bt[n][k], At[m][k], acc[ai][bj][m][n], 0, 0, 0); __builtin_amdgcn_s_setprio(0); } while (0)
#define PG8_WAIT_V(n) asm volatile("s_waitcnt vmcnt(" #n ")" ::: "memory")
#define PG8_WAIT_L(n) asm volatile("s_waitcnt lgkmcnt(" #n ")" ::: "memory")
#define PG8_BAR __builtin_amdgcn_s_barrier()
#define PG8_SCHED __builtin_amdgcn_sched_barrier(0)
    Unit cur, nxt; int ui = 0;
    if (!S.next(0, cur)) return;
    f32x4 acc[2][2][4][2];
#pragma unroll
    for (int a = 0; a < 2; ++a)
#pragma unroll
        for (int b = 0; b < 2; ++b)
#pragma unroll
            for (int m = 0; m < 4; ++m)
#pragma unroll
                for (int n = 0; n < 2; ++n) acc[a][b][m][n] = (f32x4){0.f, 0.f, 0.f, 0.f};
    bf16x8 At[4][2], B0[2][2], B1[2][2];
    const char* cA = (const char*)g.A + (size_t)cur.pm * tstep; const char* cB = (const char*)g.Bt + (size_t)cur.pn * tstep;
    S.a_ready(cur);
    if constexpr (SP2) {
        PG8_STAGE(PG8_SB(0, 0), cB, voffB); PG8_STAGE(PG8_SB(0, 1), cB + hstep, voffB); PG8_STAGE(PG8_SA(0, 0), cA, voffA); PG8_STAGE(PG8_SA(0, 1), cA + hstep, voffA);
        if (wr == 1) PG8_BAR;
        PG8_WAIT_V(2); PG8_BAR;
        PG8_STAGE(PG8_SB(1, 0), cB + kstep, voffB); PG8_STAGE(PG8_SA(1, 0), cA + kstep, voffA); PG8_STAGE(PG8_SB(1, 1), cB + hstep + kstep, voffB);
        PG8_WAIT_V(6); PG8_BAR;
    } else {
        PG8_STAGE(PG8_SB(0, 0), cB, voffB); PG8_STAGE(PG8_SA(0, 0), cA, voffA); PG8_STAGE(PG8_SB(0, 1), cB + hstep, voffB); PG8_STAGE(PG8_SA(0, 1), cA + hstep, voffA);
        if (wr == 1) PG8_BAR;
        PG8_WAIT_V(4); PG8_BAR;
        PG8_STAGE(PG8_SB(1, 0), cB + kstep, voffB); PG8_STAGE(PG8_SA(1, 0), cA + kstep, voffA); PG8_STAGE(PG8_SB(1, 1), cB + hstep + kstep, voffB);
        PG8_WAIT_V(6); PG8_BAR;
    }
    for (;;) {
        const bool has_next = S.next(ui + 1, nxt);
        const char* nA = has_next ? (const char*)g.A + (size_t)nxt.pm * tstep : cA; const char* nB = has_next ? (const char*)g.Bt + (size_t)nxt.pn * tstep : cB;
        for (int t = 0; t < nt; t += 2) {
            const bool last = (t == nt - 2);
            const char* a1 = cA + (size_t)(t + 1) * kstep;
            const char* a2 = last ? nA : cA + (size_t)(t + 2) * kstep; const char* b2 = last ? nB : cB + (size_t)(t + 2) * kstep;
            const char* a3 = a2 + kstep; const char* b3 = b2 + kstep;
            if (last && has_next) S.a_ready(nxt);
            if constexpr (SP2) {
            PG8_LDB(B0, 0, 0); PG8_LDB(B1, 0, 1); PG8_SCHED; PG8_LDA(At, 0, 0); PG8_STAGE(PG8_SA(1, 1), a1 + hstep, voffA);
            PG8_WAIT_V(8); PG8_WAIT_L(0); PG8_BAR; PG8_MMA(0, 0, At, B0); PG8_MMA(0, 1, At, B1); PG8_BAR; PG8_SCHED;
            PG8_LDA(At, 0, 1); PG8_STAGE(PG8_SB(0, 0), b2, voffB); PG8_STAGE(PG8_SB(0, 1), b2 + hstep, voffB); PG8_STAGE(PG8_SA(0, 0), a2, voffA);
            PG8_WAIT_V(8); PG8_WAIT_L(0); PG8_BAR; PG8_MMA(1, 0, At, B0); PG8_MMA(1, 1, At, B1); PG8_BAR; PG8_SCHED;
            PG8_LDB(B0, 1, 0); PG8_LDB(B1, 1, 1); PG8_SCHED; PG8_LDA(At, 1, 0); PG8_STAGE(PG8_SA(0, 1), a2 + hstep, voffA);
            PG8_WAIT_V(8); PG8_WAIT_L(0); PG8_BAR; PG8_MMA(0, 0, At, B0); PG8_MMA(0, 1, At, B1); PG8_BAR; PG8_SCHED;
            PG8_LDA(At, 1, 1); PG8_STAGE(PG8_SB(1, 0), b3, voffB); PG8_STAGE(PG8_SB(1, 1), b3 + hstep, voffB); PG8_STAGE(PG8_SA(1, 0), a3, voffA);
            PG8_WAIT_V(8); PG8_WAIT_L(0); PG8_BAR; PG8_MMA(1, 0, At, B0); PG8_MMA(1, 1, At, B1); PG8_BAR; PG8_SCHED;
            } else {
            PG8_LDB(B0, 0, 0); PG8_SCHED; PG8_LDA(At, 0, 0); PG8_STAGE(PG8_SA(1, 1), a1 + hstep, voffA);
            PG8_WAIT_L(8); PG8_BAR; PG8_WAIT_L(0); PG8_MMA(0, 0, At, B0); PG8_BAR; PG8_SCHED;
            PG8_LDB(B1, 0, 1); PG8_STAGE(PG8_SB(0, 0), b2, voffB);
            PG8_BAR; PG8_WAIT_L(0); PG8_MMA(0, 1, At, B1); PG8_BAR;
            PG8_LDA(At, 0, 1); PG8_STAGE(PG8_SA(0, 0), a2, voffA);
            PG8_BAR; PG8_WAIT_L(0); PG8_MMA(1, 0, At, B0); PG8_BAR; PG8_SCHED;
            PG8_STAGE(PG8_SB(0, 1), b2 + hstep, voffB);
            PG8_WAIT_V(6); PG8_BAR; PG8_MMA(1, 1, At, B1); PG8_BAR;
            PG8_LDB(B0, 1, 0); PG8_SCHED; PG8_LDA(At, 1, 0); PG8_STAGE(PG8_SA(0, 1), a2 + hstep, voffA);
            PG8_WAIT_L(8); PG8_BAR; PG8_WAIT_L(0); PG8_MMA(0, 0, At, B0); PG8_BAR; PG8_SCHED;
            PG8_LDB(B1, 1, 1); PG8_STAGE(PG8_SB(1, 0), b3, voffB);
            PG8_BAR; PG8_WAIT_L(0); PG8_MMA(0, 1, At, B1); PG8_BAR;
            PG8_LDA(At, 1, 1); PG8_STAGE(PG8_SA(1, 0), a3, voffA);
            PG8_BAR; PG8_WAIT_L(0); PG8_MMA(1, 0, At, B0); PG8_BAR; PG8_SCHED;
            PG8_STAGE(PG8_SB(1, 1), b3 + hstep, voffB);
            PG8_WAIT_V(6); PG8_BAR; PG8_MMA(1, 1, At, B1); PG8_BAR;
            }
        }
        if constexpr (ALIGN_EPI) { if (wr == 0) PG8_BAR; }
        if constexpr (!Epi::AFTER_DRAIN) { E(acc, cur, wr, wc, fr, fq); S.done(cur); }
        if (!has_next) break;
#pragma unroll
        for (int a = 0; a < 2; ++a)
#pragma unroll
            for (int b = 0; b < 2; ++b)
#pragma unroll
                for (int m = 0; m < 4; ++m)
#pragma unroll
                    for (int n = 0; n < 2; ++n) acc[a][b][m][n] = (f32x4){0.f, 0.f, 0.f, 0.f};
        cur = nxt; cA = nA; cB = nB; ++ui;
        if constexpr (ALIGN_EPI) { if (wr == 1) PG8_BAR; }
    }
    PG8_WAIT_V(0);
    if constexpr (!ALIGN_EPI) { if (wr == 0) PG8_BAR; }
    PG8_BAR;
    if constexpr (Epi::AFTER_DRAIN) { E.fused(acc, cur, wr, wc, fr, fq, lds, wid, lane); S.done(cur); }
#undef PG8_SA
#undef PG8_SB
#undef PG8_STAGE
#undef PG8_LDA
#undef PG8_LDB
#undef PG8_MMA
#undef PG8_WAIT_V
#undef PG8_WAIT_L
#undef PG8_BAR
#undef PG8_SCHED
}
}

constexpr int S = 8192, D = 2048, DFF = 5632, DIN = 3584, DEPTH = 4;
constexpr int U_POOL = 0, U_CV = 512, U_CG = 1024, U_LG = 1536, U_LX = 2560;
constexpr int NCHUNK = 128, TCH = 64;
constexpr float LN_EPS = 1e-5f;
constexpr int NWAVES = 8;

constexpr size_t MiB = 1u << 20;
constexpr size_t WS_CTL = 0, CTL_ZERO_BYTES = 1 * MiB;
constexpr size_t SZ_WGU = (size_t)2 * DFF * D * 2, SZ_WD = (size_t)D * DFF * 2, SZ_WIN = (size_t)DIN * D * 2, SZ_WOUT = (size_t)D * D * 2;
constexpr size_t SZ_WLRU = (size_t)2 * 2 * 8 * 128 * 128 * 2, SZ_WPOOL = (size_t)4 * 128 * 128 * 2;
constexpr size_t LW_GU1 = 0, LW_D1 = LW_GU1 + SZ_WGU, LW_IN = LW_D1 + SZ_WD, LW_OUT = LW_IN + SZ_WIN, LW_GU2 = LW_OUT + SZ_WOUT, LW_D2 = LW_GU2 + SZ_WGU,
                 LW_LRU = LW_D2 + SZ_WD, LW_POOL = LW_LRU + SZ_WLRU, LAYER_W = LW_POOL + SZ_WPOOL;
constexpr size_t WS_W = 1 * MiB;
constexpr size_t WS_XB = WS_W + DEPTH * LAYER_W;
constexpr size_t WS_XL = WS_XB + (size_t)S * D * 2;
constexpr size_t WS_ACT = WS_XL + (size_t)S * D * 2;
constexpr size_t WS_U = WS_ACT + (size_t)S * DFF * 2;
constexpr size_t WS_Y = WS_U + (size_t)S * DIN * 2;
constexpr size_t WS_SSP = WS_Y + (size_t)S * D * 2;
constexpr size_t WS_AGG = WS_SSP + (size_t)S * 8 * 4;
constexpr size_t WS_CIN = WS_AGG + (size_t)2 * NCHUNK * 1024 * 8;
constexpr size_t WS_LAB = WS_CIN + (size_t)2 * NCHUNK * 1024 * 4;
constexpr size_t WS_END = WS_LAB + (size_t)8 * NCHUNK * 2 * 4 * 512 * 16;
constexpr int CW_BAR = 4096;

constexpr int RING_OFF = 0, RING_BYTES = 131072, RSTAB_OFF = 131072;
constexpr int LDSCTL_OFF = 141312, MISC_OFF = LDSCTL_OFF + 320;
constexpr int LDS_BYTES = 147456;
static_assert(MISC_OFF + 128 <= LDS_BYTES, "LDS map");

#define GAS __attribute__((address_space(1)))
#define LAS __attribute__((address_space(3)))
typedef unsigned short bf16;
typedef unsigned v4u __attribute__((ext_vector_type(4)));
typedef float f32x4 __attribute__((ext_vector_type(4)));
typedef GAS unsigned gu32;
typedef float f32x2v __attribute__((ext_vector_type(2)));
#define RLX_AGENT __ATOMIC_RELAXED, __HIP_MEMORY_SCOPE_AGENT
#define LDS_WAIT() asm volatile("s_waitcnt lgkmcnt(0)" ::: "memory")
#define VM_WAIT() asm volatile("s_waitcnt vmcnt(0)" ::: "memory")
__device__ __forceinline__ unsigned pk2(float lo, float hi) { return pg8::cvt_pk_bf16(lo, hi); }
__device__ __forceinline__ unsigned f2bf(float f) { return pk2(f, 0.f) & 0xffffu; }
__device__ __forceinline__ float bflo(unsigned w) { return __uint_as_float(w << 16); }
__device__ __forceinline__ float bfhi(unsigned w) { return __uint_as_float(w & 0xffff0000u); }
__device__ __forceinline__ float wave_sum(float v) {
#pragma unroll
    for (int o = 1; o < 64; o <<= 1) v += __shfl_xor(v, o);
    return v;
}
__device__ __forceinline__ float sigmoid_f(float x) { return __builtin_amdgcn_rcpf(1.0f + __expf(-x)); }
__device__ __forceinline__ float gelu_tanh_f(float x) {
    const float y = 0.7978845608028654f * (x + 0.044715f * x * x * x);
    const float th = 1.0f - 2.0f * __builtin_amdgcn_rcpf(1.0f + __expf(2.0f * y));
    return 0.5f * x * (1.0f + th);
}

#define XB_TMO      128
#define XB_XCNT(j)  (256  + 64 * (j))
#define XB_XSUB(j)  (1280 + 64 * (j))
#define XB_XGEN(j)  (2304 + 64 * (j))
#define XB_TOP      3328
#define XB_TOPGEN   3392
#define XCD_BAR_WORDS 3456
#define XB_SPIN_CAP (1u << 18)

__device__ __forceinline__ unsigned xb_ld(unsigned* p)              { return __hip_atomic_load(p, __ATOMIC_RELAXED, __HIP_MEMORY_SCOPE_AGENT); }
__device__ __forceinline__ unsigned xb_add(unsigned* p, unsigned v) { return __hip_atomic_fetch_add(p, v, __ATOMIC_RELAXED, __HIP_MEMORY_SCOPE_AGENT); }
__device__ __forceinline__ unsigned xb_xcc_id() { return (unsigned)__builtin_amdgcn_s_getreg((3 << 11) | 20) & 0xFu; }
#define XB_SPIN(cond, bar) do { unsigned _sp = 0; while (cond) { __builtin_amdgcn_s_sleep(1); \
    if ((++_sp & 255u) == 0u) { if (xb_ld(&(bar)[XB_TMO])) break; if (_sp > XB_SPIN_CAP) { atomicAdd(&(bar)[XB_TMO], 1u); break; } } } } while (0)

struct XcdBarrier {
    unsigned* bar; unsigned x;
    volatile LAS unsigned* st;
};

__device__ __forceinline__ XcdBarrier xcd_barrier_post(unsigned* bar, volatile LAS unsigned* st) {
    XcdBarrier b; b.bar = bar; b.x = xb_xcc_id(); b.st = st;
    if (threadIdx.x == 0) (void)xb_add(&bar[XB_XCNT(b.x)], 1u);
    return b;
}
__device__ __forceinline__ void xcd_barrier_complete(unsigned* bar, unsigned x, unsigned& nloc, unsigned& nx) {
    const unsigned G = gridDim.x * gridDim.y * gridDim.z;
    unsigned sum, cnt, mine, sp = 0u;
    for (;;) {
        sum = 0u; cnt = 0u; mine = 0u;
#pragma unroll
        for (unsigned j = 0; j < 16; ++j) { const unsigned c = xb_ld(&bar[XB_XCNT(j)]); sum += c; cnt += (c > 0u) ? 1u : 0u; mine = (j == x) ? c : mine; }
        if (sum == G) break;
        __builtin_amdgcn_s_sleep(1);
        if ((++sp & 255u) == 0u) { if (xb_ld(&bar[XB_TMO])) break; if (sp > XB_SPIN_CAP) { atomicAdd(&bar[XB_TMO], 1u); break; } }
    }
    nloc = mine > 0u ? mine : 1u; nx = cnt > 0u ? cnt : 1u;
}

__device__ __forceinline__ void xcd_barrier(const XcdBarrier& b) {
    asm volatile("s_waitcnt vmcnt(0)" ::: "memory");
    __syncthreads();
    if (threadIdx.x == 0) {
        unsigned* bar = b.bar;
        __builtin_amdgcn_s_waitcnt(0);
        unsigned nloc = b.st[0], nx = b.st[1];
        if (nloc == 0u) { xcd_barrier_complete(bar, b.x, nloc, nx); b.st[0] = nloc; b.st[1] = nx; }
        const unsigned old = xb_add(&bar[XB_XSUB(b.x)], 1u);
        const unsigned gen = old / nloc;
        if (old + 1u == (gen + 1u) * nloc) {
            __builtin_amdgcn_fence(__ATOMIC_RELEASE, "agent");
            asm volatile("s_waitcnt vmcnt(0)" ::: "memory");
            const unsigned og = xb_add(&bar[XB_TOP], 1u);
            const unsigned tg = og / nx;
            if (og + 1u == (tg + 1u) * nx) xb_add(&bar[XB_TOPGEN], 1u);
            else XB_SPIN(xb_ld(&bar[XB_TOPGEN]) == tg, bar);
            __builtin_amdgcn_fence(__ATOMIC_ACQUIRE, "agent");
            xb_add(&bar[XB_XGEN(b.x)], 1u);
            asm volatile("s_waitcnt vmcnt(0)" ::: "memory");
        } else {
            XB_SPIN(xb_ld(&bar[XB_XGEN(b.x)]) == gen, bar);
            __builtin_amdgcn_fence(__ATOMIC_ACQUIRE, "agent");
            asm volatile("s_waitcnt vmcnt(0)" ::: "memory");
        }
    }
    __syncthreads();
}

struct Args { const float* in[26]; float* out; unsigned char* ws; int ph_lo, ph_hi; };

constexpr int I_FF = (D / 64) * (DFF / 64);
constexpr int I_IN = (D / 64) * (DIN / 64);
constexpr int I_OUT = (D / 64) * (D / 64);
constexpr int I_LRU = 2 * 16 * 4, I_POOL = 16;
constexpr int ITEMS_L = 6 * I_FF + I_IN + I_OUT + I_LRU + I_POOL;
constexpr size_t WS_TAB = 512 * 1024;
__device__ __forceinline__ const float* tabp(unsigned char* w, int k) { return ((const float* const*)(w + WS_TAB))[k]; }
struct ArgsProv { const Args& a; __device__ __forceinline__ const float* in(int k) const { return a.in[k]; } __device__ __forceinline__ unsigned char* ws() const { return a.ws; } };
struct TabProv {
    unsigned char* w; const float *p1, *p2, *p3, *p4, *p5, *p6, *p7, *p15, *p17, *p20, *p21, *p22, *p23, *p24;
    __device__ __forceinline__ static const float* ld(unsigned char* w, int k) { const unsigned long long v = ((const GAS unsigned long long*)(w + WS_TAB))[k];
        const unsigned lo = __builtin_amdgcn_readfirstlane((unsigned)v), hi = __builtin_amdgcn_readfirstlane((unsigned)(v >> 32)); return (const float*)(((unsigned long long)hi << 32) | lo); }
    __device__ __forceinline__ explicit TabProv(unsigned char* w_) : w(w_), p1(ld(w_, 1)), p2(ld(w_, 2)), p3(ld(w_, 3)), p4(ld(w_, 4)), p5(ld(w_, 5)), p6(ld(w_, 6)), p7(ld(w_, 7)), p15(ld(w_, 15)), p17(ld(w_, 17)),
        p20(ld(w_, 20)), p21(ld(w_, 21)), p22(ld(w_, 22)), p23(ld(w_, 23)), p24(ld(w_, 24)) {}
    __device__ __forceinline__ const float* in(int k) const {
        switch (k) { case 1: return p1; case 2: return p2; case 3: return p3; case 4: return p4; case 5: return p5; case 6: return p6; case 7: return p7; case 15: return p15; case 17: return p17;
                     case 20: return p20; case 21: return p21; case 22: return p22; case 23: return p23; default: return p24; } }
    __device__ __forceinline__ unsigned char* ws() const { return w; }
};
struct CvtJob { const float* src; const float* gain; bf16* dst; int ldn, ldk, k0, n0, drow; };
constexpr int R_D1 = 2 * I_FF, R_IN = R_D1 + I_FF, R_LRU = R_IN + I_IN, R_POOL = R_LRU + I_LRU, R_OUT = R_POOL + I_POOL, R_GU2 = R_OUT + I_OUT, R_D2 = R_GU2 + 2 * I_FF;
static_assert(R_D2 + I_FF == ITEMS_L, "item map");
template <class Prov> __device__ __forceinline__ CvtJob gu_job(const Prov& P, int bi, int l, int r, unsigned char* wgu) {
    CvtJob j; const int m = r >= I_FF ? 1 : 0, rr = r - m * I_FF; const int kb = rr / (DFF / 64), nb = rr - kb * (DFF / 64);
    j.src = P.in(bi + 1 + m) + (size_t)l * D * DFF; j.ldn = DFF; j.k0 = 64 * kb; j.n0 = 64 * nb;
    j.dst = (bf16*)wgu; j.ldk = D; j.drow = 256 * (j.n0 >> 7) + (j.n0 & 127) + 128 * m; j.gain = P.in(bi) + (size_t)l * D; return j;
}
template <class Prov> __device__ __forceinline__ CvtJob dn_job(const Prov& P, int bi, int l, int r, unsigned char* wd) {
    CvtJob j; const int kb = r / (D / 64), nb = r - kb * (D / 64); j.src = P.in(bi + 3) + (size_t)l * DFF * D; j.ldn = D; j.k0 = 64 * kb; j.n0 = 64 * nb;
    j.dst = (bf16*)wd; j.ldk = DFF; j.drow = j.n0; j.gain = nullptr; return j;
}
template <class Prov> __device__ __forceinline__ CvtJob cvt_decode(const Prov& P, int it) {
    const int l = it / ITEMS_L; const int r = it - l * ITEMS_L;
    unsigned char* wl = P.ws() + WS_W + (size_t)l * LAYER_W;
    if (r < R_D1) return gu_job(P, 1, l, r, wl + LW_GU1);
    if (r < R_IN) return dn_job(P, 1, l, r - R_D1, wl + LW_D1);
    CvtJob j;
    if (r < R_LRU) { const int q = r - R_IN, kb = q / (DIN / 64), nb = q - kb * (DIN / 64); j.src = P.in(6) + (size_t)l * D * DIN; j.ldn = DIN; j.k0 = 64 * kb; j.n0 = 64 * nb;
        j.dst = (bf16*)(wl + LW_IN); j.ldk = D; j.drow = j.n0; j.gain = P.in(5) + (size_t)l * D; return j; }
    if (r < R_POOL) { const int q = r - R_LRU, which = q >> 6, rr = q & 63, mi = rr >> 2, sub = rr & 3;
        j.src = P.in(which ? 17 : 15) + (size_t)l * (2 * 8 * 16384) + (size_t)mi * 16384; j.ldn = 128; j.k0 = 64 * (sub >> 1); j.n0 = 64 * (sub & 1);
        const int d = mi >> 3, h = mi & 7; j.dst = (bf16*)(wl + LW_LRU) + (size_t)((d * 2 + which) * 8 + h) * 16384; j.ldk = 128; j.drow = j.n0; j.gain = nullptr; return j; }
    if (r < R_OUT) { const int q = r - R_POOL, mi = q >> 2, sub = q & 3; j.src = P.in(7) + (size_t)l * (4 * 16384) + (size_t)mi * 16384; j.ldn = 128; j.k0 = 64 * (sub >> 1); j.n0 = 64 * (sub & 1);
        j.dst = (bf16*)(wl + LW_POOL) + (size_t)mi * 16384; j.ldk = 128; j.drow = j.n0; j.gain = nullptr; return j; }
    if (r < R_GU2) { const int q = r - R_OUT, kb = q / (D / 64), nb = q - kb * (D / 64); j.src = P.in(20) + (size_t)l * D * D; j.ldn = D; j.k0 = 64 * kb; j.n0 = 64 * nb;
        j.dst = (bf16*)(wl + LW_OUT); j.ldk = D; j.drow = j.n0; j.gain = nullptr; return j; }
    if (r < R_D2) return gu_job(P, 21, l, r - R_GU2, wl + LW_GU2);
    return dn_job(P, 21, l, r - R_D2, wl + LW_D2);
}
struct CvtRegs { f32x4 v[16]; f32x4 g[4]; };
__device__ __forceinline__ void cvt_load(const CvtJob& j, int lane, CvtRegs& R) {
    const int kq = lane >> 4, c4 = 4 * (lane & 15);
    const float* sp = j.src + (size_t)(j.k0 + 16 * kq) * j.ldn + j.n0 + c4;
#pragma unroll
    for (int i = 0; i < 16; ++i) R.v[i] = __builtin_nontemporal_load((const GAS f32x4*)(sp + (size_t)i * j.ldn));
    if (j.gain) {
#pragma unroll
        for (int i = 0; i < 4; ++i) R.g[i] = *(const GAS f32x4*)(j.gain + j.k0 + 16 * kq + 4 * i);
    } else {
#pragma unroll
        for (int i = 0; i < 4; ++i) R.g[i] = (f32x4){1.f, 1.f, 1.f, 1.f};
    }
}
__device__ __forceinline__ void cvt_store(const CvtJob& j, LAS float* scr, int lane, const CvtRegs& R) {
    (void)scr;
    const int kq = lane >> 4, c4 = 4 * (lane & 15);
    bf16* dp = j.dst + (size_t)(j.drow + c4) * j.ldk + j.k0 + 16 * kq;
#pragma unroll
    for (int e = 0; e < 4; ++e) {
        v4u o0, o1;
        o0.x = pk2(R.v[0][e] * R.g[0][0], R.v[1][e] * R.g[0][1]); o0.y = pk2(R.v[2][e] * R.g[0][2], R.v[3][e] * R.g[0][3]);
        o0.z = pk2(R.v[4][e] * R.g[1][0], R.v[5][e] * R.g[1][1]); o0.w = pk2(R.v[6][e] * R.g[1][2], R.v[7][e] * R.g[1][3]);
        o1.x = pk2(R.v[8][e] * R.g[2][0], R.v[9][e] * R.g[2][1]); o1.y = pk2(R.v[10][e] * R.g[2][2], R.v[11][e] * R.g[2][3]);
        o1.z = pk2(R.v[12][e] * R.g[3][0], R.v[13][e] * R.g[3][1]); o1.w = pk2(R.v[14][e] * R.g[3][2], R.v[15][e] * R.g[3][3]);
        *(GAS v4u*)(dp + (size_t)e * j.ldk) = o0; *(GAS v4u*)(dp + (size_t)e * j.ldk + 8) = o1; }
}
template <class Prov> __device__ __forceinline__ void cvt_range(const Prov& P, LAS float* scr, int lane, int g0, int g1, int iw, int NW) {
    int it = g0 + iw; if (it >= g1) return;
    CvtJob ja = cvt_decode(P, it), jb = ja; CvtRegs Ra, Rb; cvt_load(ja, lane, Ra);
    for (;;) {
        bool more = it + NW < g1;
        if (more) { jb = cvt_decode(P, it + NW); cvt_load(jb, lane, Rb); }
        cvt_store(ja, scr, lane, Ra);
        if (!more) break;
        it += NW; more = it + NW < g1;
        if (more) { ja = cvt_decode(P, it + NW); cvt_load(ja, lane, Ra); }
        cvt_store(jb, scr, lane, Rb);
        if (!more) break;
        it += NW;
    }
}
constexpr int CV_P0 = 2 * I_FF, CV_Q1 = 8192, CV_Q2 = 3584, CV_TOTAL = DEPTH * ITEMS_L;
static_assert(CV_Q1 >= (R_OUT + I_OUT) - R_D1, "GU(l,0)'s share covers d1, w_in, lru, pool, w_out (used before the next converting phase ends)");
static_assert(CV_Q1 + CV_Q2 >= R_D2 - R_D1, "... and WIN(l)'s share reaches the end of gu2 (used by GU(l,1) itself)");

__device__ __forceinline__ unsigned char* opaque_ptr(unsigned char* p) {
    unsigned lo_ = (unsigned)(uintptr_t)p, hi_ = (unsigned)((uintptr_t)p >> 32);
    lo_ = __builtin_amdgcn_readfirstlane(lo_); hi_ = __builtin_amdgcn_readfirstlane(hi_);
    asm volatile("" : "+s"(lo_), "+s"(hi_));
    return (unsigned char*)(((uintptr_t)hi_ << 32) | (uintptr_t)lo_);
}
#define OPAQUE_V(x) asm volatile("" : "+v"(x))
__device__ __forceinline__ int opaque_s32(int v) { v = __builtin_amdgcn_readfirstlane(v); asm volatile("" : "+s"(v)); return v; }
struct Ids { int tid, lane, wave, gw, NGW, gt, GT, G; };
__device__ __forceinline__ Ids make_ids() {
    Ids I; int t = threadIdx.x; OPAQUE_V(t); I.tid = t; I.lane = t & 63; I.wave = __builtin_amdgcn_readfirstlane(t >> 6); I.G = opaque_s32((int)gridDim.x); const int bid = opaque_s32((int)blockIdx.x);
    I.gw = bid * NWAVES + I.wave; I.NGW = I.G * NWAVES; I.gt = bid * (NWAVES * 64) + t; I.GT = I.G * NWAVES * 64; return I;
}
__device__ __forceinline__ void grid_sync(unsigned char* w, LAS unsigned char* lds) {
    XcdBarrier b; b.bar = (unsigned*)(w + WS_CTL) + CW_BAR; b.x = xb_xcc_id(); b.st = (volatile LAS unsigned*)(lds + MISC_OFF) + 8;
    xcd_barrier(b);
}

__device__ __forceinline__ void ph_prologue(const Args& args, LAS unsigned char* lds) {
    const Ids I = make_ids();
    if (I.tid == 0) { const float** tab = (const float**)(args.ws + WS_TAB);
#pragma unroll
        for (int k = 0; k < 26; ++k) tab[k] = args.in[k];
        tab[26] = args.out; }
    LAS float* scr = (LAS float*)(lds + I.wave * 17408);
    { const ArgsProv P{args}; cvt_range(P, scr, I.lane, 0, CV_P0, I.gw, I.NGW); }
    const float* x = args.in[0]; bf16* XB = (bf16*)(args.ws + WS_XB); float* SSP = (float*)(args.ws + WS_SSP);
    for (int m0 = I.gw; m0 < S; m0 += 2 * I.NGW) {
        f32x4 v[2][8];
#pragma unroll
        for (int q = 0; q < 2; ++q) { const int m = m0 + q * I.NGW; const GAS f32x4* xr = (const GAS f32x4*)(x + (size_t)(m < S ? m : m0) * D) + I.lane;
#pragma unroll
            for (int j = 0; j < 8; ++j) v[q][j] = xr[64 * j]; }
#pragma unroll
        for (int q = 0; q < 2; ++q) { const int m = m0 + q * I.NGW; if (m >= S) continue;
            GAS unsigned long long* o8 = (GAS unsigned long long*)(XB + (size_t)m * D) + I.lane;
#pragma unroll
            for (int j = 0; j < 8; ++j) { const f32x4 vv = v[q][j];
                o8[64 * j] = (unsigned long long)pk2(vv[0], vv[1]) | ((unsigned long long)pk2(vv[2], vv[3]) << 32);
                const float s = wave_sum((vv[0] * vv[0] + vv[1] * vv[1]) + (vv[2] * vv[2] + vv[3] * vv[3]));
                if (I.lane == 0) *(GAS float*)(SSP + (size_t)m * 8 + j) = s; } }
    }
}
__device__ __forceinline__ void ph_gateup(unsigned char* w, LAS unsigned char* lds, int l, int f) {
    unsigned char* wl = w + WS_W + (size_t)l * LAYER_W;
    pg8::Gemm g{(const bf16*)(w + WS_XB), (const bf16*)(wl + (f ? LW_GU2 : LW_GU1)), S, 2 * DFF, D}; pg8::StaticOrder So; So.init(S, 2 * DFF, opaque_s32((int)gridDim.x), opaque_s32((int)blockIdx.x));
    pg8::Unit u0; u0.pm = 0; u0.pn = 0; (void)So.next(0, u0);
    LAS float* rs_tab = (LAS float*)(lds + RSTAB_OFF);
    { int t = threadIdx.x; OPAQUE_V(t); if (t < 256) rs_tab[t] = pg8::row_rstd((const float*)(w + WS_SSP), u0.pm * 256 + t); }
    __syncthreads();
    pg8::EpiSwiglu E{(bf16*)(w + WS_ACT), DFF, (const float*)(w + WS_SSP), rs_tab, u0.pm};
    pg8::gemm_phase<pg8::EpiSwiglu, pg8::StaticOrder, true, true>(lds + RING_OFF, g, So, E);
    const int bid = opaque_s32((int)blockIdx.x);
    if (bid >= 128) {
        const int base = l * ITEMS_L + CV_P0, g0 = f ? base + CV_Q1 + CV_Q2 : base; int g1 = f ? base + ITEMS_L : base + CV_Q1; g1 = g1 > CV_TOTAL ? CV_TOTAL : g1;
        int t = threadIdx.x; OPAQUE_V(t); const int wave = __builtin_amdgcn_readfirstlane(t >> 6);
        const TabProv P(opaque_ptr(w)); cvt_range(P, (LAS float*)(lds + wave * 17408), t & 63, g0, g1, (bid - 128) * NWAVES + wave, 128 * NWAVES); }
}
__device__ __forceinline__ void ph_down(unsigned char* w, LAS unsigned char* lds, int l, int f) {
    unsigned char* wl = w + WS_W + (size_t)l * LAYER_W;
    pg8::Gemm g{(const bf16*)(w + WS_ACT), (const bf16*)(wl + (f ? LW_D2 : LW_D1)), S, D, DFF}; pg8::StaticOrder So; So.init(S, D, opaque_s32((int)gridDim.x), opaque_s32((int)blockIdx.x));
    pg8::EpiResid E{(bf16*)(w + WS_XB), (float*)(w + WS_SSP), 0.5f};
    pg8::gemm_phase<pg8::EpiResid, pg8::StaticOrder, false, true>(lds + RING_OFF, g, So, E);
}
__device__ __forceinline__ void ph_win(unsigned char* w, LAS unsigned char* lds, int l) {
    unsigned char* wl = w + WS_W + (size_t)l * LAYER_W;
    pg8::Gemm g{(const bf16*)(w + WS_XB), (const bf16*)(wl + LW_IN), S, DIN, D}; pg8::StaticOrder So; So.init(S, DIN, opaque_s32((int)gridDim.x), opaque_s32((int)blockIdx.x));
    pg8::Unit u0; u0.pm = 0; u0.pn = 0; (void)So.next(0, u0);
    LAS float* rs_tab = (LAS float*)(lds + RSTAB_OFF);
    { int t = threadIdx.x; OPAQUE_V(t); if (t < 256) rs_tab[t] = pg8::row_rstd((const float*)(w + WS_SSP), u0.pm * 256 + t); }
    __syncthreads();
    pg8::EpiScaleBf16 E{(bf16*)(w + WS_U), DIN, (const float*)(w + WS_SSP), rs_tab, u0.pm};
    pg8::gemm_phase<pg8::EpiScaleBf16, pg8::StaticOrder, true, true>(lds + RING_OFF, g, So, E);
    const int bid = opaque_s32((int)blockIdx.x);
    if (bid >= 192) {
        const int base = l * ITEMS_L + CV_P0, g0 = base + CV_Q1, g1 = base + CV_Q1 + CV_Q2;
        int t = threadIdx.x; OPAQUE_V(t); const int wave = __builtin_amdgcn_readfirstlane(t >> 6);
        const TabProv P(opaque_ptr(w)); cvt_range(P, (LAS float*)(lds + wave * 17408), t & 63, g0, g1, (bid - 192) * NWAVES + wave, 64 * NWAVES); }
}
__device__ __forceinline__ void ph_wout(unsigned char* w, LAS unsigned char* lds, int l) {
    unsigned char* wl = w + WS_W + (size_t)l * LAYER_W;
    pg8::Gemm g{(const bf16*)(w + WS_Y), (const bf16*)(wl + LW_OUT), S, D, D}; pg8::StaticOrder So; So.init(S, D, opaque_s32((int)gridDim.x), opaque_s32((int)blockIdx.x));
    pg8::EpiResid E{(bf16*)(w + WS_XB), (float*)(w + WS_SSP), 1.0f};
    pg8::gemm_phase<pg8::EpiResid, pg8::StaticOrder, false, true>(lds + RING_OFF, g, So, E);
}
__device__ __forceinline__ void ph_final(unsigned char* w) {
    const Ids I = make_ids(); float* X = (float*)tabp(w, 26); const float* gf = tabp(w, 25); const bf16* XB = (const bf16*)(w + WS_XB);
    for (int m = I.gw; m < S; m += I.NGW) { GAS f32x4* xr = (GAS f32x4*)(X + (size_t)m * D) + I.lane; const GAS f32x4* gr = (const GAS f32x4*)gf + I.lane;
        const GAS unsigned long long* h8 = (const GAS unsigned long long*)(XB + (size_t)m * D) + I.lane;
        f32x4 v[8]; float s = 0.f;
#pragma unroll
        for (int j = 0; j < 8; ++j) { const unsigned long long h = h8[64 * j];
            v[j][0] = bflo((unsigned)h); v[j][1] = bfhi((unsigned)h); v[j][2] = bflo((unsigned)(h >> 32)); v[j][3] = bfhi((unsigned)(h >> 32));
            s += (v[j][0] * v[j][0] + v[j][1] * v[j][1]) + (v[j][2] * v[j][2] + v[j][3] * v[j][3]); }
        const float rs = rsqrtf(wave_sum(s) * (1.0f / (float)D) + pg8::RMS_EPS);
#pragma unroll
        for (int j = 0; j < 8; ++j) xr[64 * j] = v[j] * rs * gr[64 * j]; }
}

typedef short bf16x8 __attribute__((ext_vector_type(8)));
constexpr int LR_XR = 0, LR_XCB0 = 17920, LR_XCB1 = 35328, LR_XCF0 = 52736, LR_XCF1 = 85760, LR_CS = 118784, LR_HO0 = 0, LR_HO1 = 33024;
constexpr int PO_PT = 0, PO_PA = 20480;
constexpr int CV_Z = 0, CV_O = 63488;
static_assert(LR_XCF1 + 64 * 129 * 4 <= LR_CS && LR_CS + 4 * 128 * 8 * 4 <= LDSCTL_OFF && CV_O + 32 * 512 * 4 <= LDSCTL_OFF, "mixer LDS maps");

__device__ __forceinline__ void conv_units(unsigned char* w, LAS unsigned char* lds, int l, const Ids& I) {
    const bf16* U = (const bf16*)(w + WS_U); bf16* Y = (bf16*)(w + WS_Y);
    const GAS float* dw = (const GAS float*)(tabp(w, 9) + (size_t)l * (31 * 512)); const GAS float* db = (const GAS float*)(tabp(w, 10) + (size_t)l * 512); const GAS float* lg = (const GAS float*)(tabp(w, 11) + (size_t)l * 512); const GAS float* lb = (const GAS float*)(tabp(w, 12) + (size_t)l * 512);
    LAS float* Z = (LAS float*)(lds + CV_Z); LAS float* O = (LAS float*)(lds + CV_O);
    const int bid = I.gw / NWAVES;
    for (int u = bid; u < S / 32; u += I.G) { const int t0 = 32 * u;
        v4u vpre[4], gpre[4];
#pragma unroll
        for (int e = 0; e < 4; ++e) { const int q = I.tid + e * NWAVES * 64, row = q >> 5, c8 = (q & 31) * 8, t = t0 - 15 + row; vpre[e] = (v4u){0u, 0u, 0u, 0u}; gpre[e] = vpre[e];
            if (q < 62 * 32 && t >= 0 && t < S) { vpre[e] = *(const GAS v4u*)(U + (size_t)t * DIN + U_CV + c8); gpre[e] = *(const GAS v4u*)(U + (size_t)t * DIN + U_CG + c8); } }
#pragma unroll 1
        for (int hf = 0; hf < 2; ++hf) {
            float wk[31]; const float bias = db[256 * hf + (I.tid & 255)];
#pragma unroll
            for (int k = 0; k < 31; ++k) wk[k] = dw[(size_t)k * 512 + 256 * hf + (I.tid & 255)];
#pragma unroll
            for (int e = 0; e < 4; ++e) { const int q = I.tid + e * NWAVES * 64, row = q >> 5, c8 = (q & 31) * 8, t = t0 - 15 + row; if (q >= 62 * 32) continue;
                f32x4 z0 = (f32x4){0.f, 0.f, 0.f, 0.f}, z1 = z0;
                if (t >= 0 && t < S) { const v4u vv = vpre[e], gg = gpre[e];
                    z0[0] = bflo(vv.x) * sigmoid_f(bflo(gg.x)); z0[1] = bfhi(vv.x) * sigmoid_f(bfhi(gg.x)); z0[2] = bflo(vv.y) * sigmoid_f(bflo(gg.y)); z0[3] = bfhi(vv.y) * sigmoid_f(bfhi(gg.y));
                    z1[0] = bflo(vv.z) * sigmoid_f(bflo(gg.z)); z1[1] = bfhi(vv.z) * sigmoid_f(bfhi(gg.z)); z1[2] = bflo(vv.w) * sigmoid_f(bflo(gg.w)); z1[3] = bfhi(vv.w) * sigmoid_f(bfhi(gg.w)); }
                *(LAS f32x4*)(Z + row * 256 + c8) = z0; *(LAS f32x4*)(Z + row * 256 + c8 + 4) = z1; }
            if (hf == 0) {
#pragma unroll
                for (int e = 0; e < 4; ++e) { const int q = I.tid + e * NWAVES * 64, row = q >> 5, c8 = (q & 31) * 8, t = t0 - 15 + row; vpre[e] = (v4u){0u, 0u, 0u, 0u}; gpre[e] = vpre[e];
                    if (q < 62 * 32 && t >= 0 && t < S) { vpre[e] = *(const GAS v4u*)(U + (size_t)t * DIN + U_CV + 256 + c8); gpre[e] = *(const GAS v4u*)(U + (size_t)t * DIN + U_CG + 256 + c8); } } }
            __syncthreads();
            { const int c = I.tid & 255, tg = I.tid >> 8, ch = 256 * hf + c;
                float acc[16];
#pragma unroll
                for (int i = 0; i < 16; ++i) acc[i] = bias;
#pragma unroll
                for (int r = 0; r < 46; ++r) { const float zv = Z[(16 * tg + r) * 256 + c];
#pragma unroll
                    for (int i = 0; i < 16; ++i) { const int k = r - i; if (k >= 0 && k <= 30) acc[i] += wk[k] * zv; } }
#pragma unroll
                for (int i = 0; i < 16; ++i) O[(16 * tg + i) * 512 + ch] = acc[i]; }
            __syncthreads();
        }
        const f32x4 lg0 = *(const GAS f32x4*)(lg + 8 * I.lane), lg1 = *(const GAS f32x4*)(lg + 8 * I.lane + 4), lb0 = *(const GAS f32x4*)(lb + 8 * I.lane), lb1 = *(const GAS f32x4*)(lb + 8 * I.lane + 4);
#pragma unroll
        for (int i = 0; i < 4; ++i) { const int tl = 4 * I.wave + i, c8 = 8 * I.lane;
            f32x4 a0 = *(const LAS f32x4*)(O + tl * 512 + c8), a1 = *(const LAS f32x4*)(O + tl * 512 + c8 + 4);
            const float mean = wave_sum(((a0[0] + a0[1]) + (a0[2] + a0[3])) + ((a1[0] + a1[1]) + (a1[2] + a1[3]))) * (1.0f / 512.0f);
            a0 = a0 - mean; a1 = a1 - mean;
            const float var = wave_sum(((a0[0] * a0[0] + a0[1] * a0[1]) + (a0[2] * a0[2] + a0[3] * a0[3])) + ((a1[0] * a1[0] + a1[1] * a1[1]) + (a1[2] * a1[2] + a1[3] * a1[3]))) * (1.0f / 512.0f);
            const float rstd = rsqrtf(var + LN_EPS);
            a0 = a0 * rstd * lg0 + lb0; a1 = a1 * rstd * lg1 + lb1;
            v4u o; o.x = pk2(pg8::silu_f(a0[0]), pg8::silu_f(a0[1])); o.y = pk2(pg8::silu_f(a0[2]), pg8::silu_f(a0[3])); o.z = pk2(pg8::silu_f(a1[0]), pg8::silu_f(a1[1])); o.w = pk2(pg8::silu_f(a1[2]), pg8::silu_f(a1[3]));
            *(GAS v4u*)(Y + (size_t)(t0 + tl) * D + 512 + c8) = o; }
        __syncthreads();
    }
}

__device__ __forceinline__ void pool_units(unsigned char* w, LAS unsigned char* lds, int l, const Ids& I) {
    const bf16* U = (const bf16*)(w + WS_U); GAS bf16* Y = (GAS bf16*)(w + WS_Y);
    const bf16* WpT = (const bf16*)(w + WS_W + (size_t)l * LAYER_W + LW_POOL); const GAS float* psc = (const GAS float*)(tabp(w, 8) + (size_t)l * 512);
    LAS unsigned char* PT = lds + PO_PT; LAS unsigned char* PA = lds + PO_PA;
    const int bid = I.gw / NWAVES, fr = I.lane & 15, fq = I.lane >> 4;
    const int g = bid & 3, half = 1 << g;
    v4u ppre[3]; bf16x8 Bp[4]; f32x4 sc4;
    if (bid < 4 * NCHUNK) { const int t0 = (bid >> 2) * TCH;
#pragma unroll
        for (int e = 0; e < 3; ++e) { const int q = I.tid + e * NWAVES * 64, row = q >> 4, c16 = q & 15, t = t0 - 8 + row;
            ppre[e] = (v4u){0u, 0u, 0u, 0u}; if (q < 80 * 16 && t >= 0 && t < S) ppre[e] = *(const GAS v4u*)(U + (size_t)t * DIN + U_POOL + 128 * g + 8 * c16); }
#pragma unroll
        for (int ks = 0; ks < 4; ++ks) Bp[ks] = *(const GAS bf16x8*)(WpT + (size_t)g * 16384 + (16 * I.wave + fr) * 128 + 32 * ks + 8 * fq);
        sc4 = *(const GAS f32x4*)(psc + 128 * g + 16 * I.wave + 4 * fq); }
    for (int u = bid; u < 4 * NCHUNK; u += I.G) { const int t0 = (u >> 2) * TCH;
#pragma unroll
        for (int e = 0; e < 3; ++e) { const int q = I.tid + e * NWAVES * 64; if (q < 80 * 16) *(LAS v4u*)(PT + q * 16) = ppre[e]; }
        __syncthreads();
        { const int un = u + I.G;
            if (un < 4 * NCHUNK) { const int t0n = (un >> 2) * TCH;
#pragma unroll
                for (int e = 0; e < 3; ++e) { const int q = I.tid + e * NWAVES * 64, row = q >> 4, c16 = q & 15, t = t0n - 8 + row;
                    ppre[e] = (v4u){0u, 0u, 0u, 0u}; if (q < 80 * 16 && t >= 0 && t < S) ppre[e] = *(const GAS v4u*)(U + (size_t)t * DIN + U_POOL + 128 * g + 8 * c16); } } }
        { const int cp = I.tid & 63, tg = I.tid >> 6; const LAS unsigned char* col = PT + cp * 4;
            float s0 = 0.f, s1 = 0.f;
            for (int j = 0; j < 2 * half; ++j) { const unsigned v = *(const LAS unsigned*)(col + (8 * tg + 8 - half + j) * 256); s0 += bflo(v); s1 += bfhi(v); }
#pragma unroll
            for (int i = 0; i < 8; ++i) { const int tl = 8 * tg + i, t = t0 + tl; const int plo = (t - half) < 0 ? 0 : (t - half), phi = (t + half) > S ? S : (t + half);
                const float inv = 1.0f / (float)(phi - plo); const unsigned ut = *(const LAS unsigned*)(col + (tl + 8) * 256);
                *(LAS unsigned*)(PA + tl * 272 + cp * 4) = pk2(s0 * inv - bflo(ut), s1 * inv - bfhi(ut));
                if (i < 7) { const unsigned va = *(const LAS unsigned*)(col + (tl + 8 + half) * 256), vs = *(const LAS unsigned*)(col + (tl + 8 - half) * 256);
                    s0 += bflo(va) - bflo(vs); s1 += bfhi(va) - bfhi(vs); } } }
        __syncthreads();
#pragma unroll
        for (int mt = 0; mt < 4; ++mt) { pg8::f32x4 acc = (pg8::f32x4){0.f, 0.f, 0.f, 0.f};
#pragma unroll
            for (int ks = 0; ks < 4; ++ks) { const bf16x8 a = *(const LAS bf16x8*)(PA + (16 * mt + fr) * 272 + ks * 64 + fq * 16); acc = __builtin_amdgcn_mfma_f32_16x16x32_bf16(Bp[ks], a, acc, 0, 0, 0); }
            *(GAS f32x2v*)(Y + (size_t)(t0 + 16 * mt + fr) * D + 128 * g + 16 * I.wave + 4 * fq) = (f32x2v){__uint_as_float(pk2(acc[0] * sc4[0], acc[1] * sc4[1])), __uint_as_float(pk2(acc[2] * sc4[2], acc[3] * sc4[3]))}; }
    }
    __syncthreads();
}

typedef _Float16 h16x2 __attribute__((ext_vector_type(2)));
__device__ __forceinline__ unsigned pk_h2(float lo, float hi) { const h16x2 v = {(_Float16)lo, (_Float16)hi}; return __builtin_bit_cast(unsigned, v); }
__device__ __forceinline__ float h2lo(unsigned w) { return (float)__builtin_bit_cast(h16x2, w).x; }
__device__ __forceinline__ float h2hi(unsigned w) { return (float)__builtin_bit_cast(h16x2, w).y; }
constexpr float LOG2E = 1.4426950408889634f;
constexpr int L1_XR = 0, L1_XRB = 17920, L1_XCB = 35840, L1_XCBB = 17408;
static_assert(L1_XCB + 4 * L1_XCBB <= LDSCTL_OFF, "pass 1 LDS map");
typedef float f32x2 __attribute__((ext_vector_type(2)));
__device__ __forceinline__ void lru_pass1(unsigned char* w, LAS unsigned char* lds, int l, const Ids& I) {
    const bf16* U = (const bf16*)(w + WS_U); float* AGG = (float*)(w + WS_AGG); GAS v4u* LAB = (GAS v4u*)(w + WS_LAB);
    const bf16* WT = (const bf16*)(w + WS_W + (size_t)l * LAYER_W + LW_LRU);
    const GAS float* cw = (const GAS float*)(tabp(w, 13) + (size_t)l * (2 * 4 * 1024)); const GAS float* cb = (const GAS float*)(tabp(w, 14) + (size_t)l * (2 * 1024));
    const GAS float* ba = (const GAS float*)(tabp(w, 16) + (size_t)l * 2048); const GAS float* bx = (const GAS float*)(tabp(w, 18) + (size_t)l * 2048); const GAS float* lam = (const GAS float*)(tabp(w, 19) + (size_t)l * 2048);
    const int bid = I.gw / NWAVES, fr = I.lane & 15, fq = I.lane >> 4, jc = 16 * I.wave + fr;
    const int cp = I.tid & 63, tg = I.tid >> 6;
    if (bid >= 8 * NCHUNK) return;
    v4u xpre[3];
    bf16x8 Bf[2][2][4]; float nA[2], nX[2], cc[2]; float cwv[2][4][2], cbv[2][2];
    const int hd = bid & 7;
    const int ksel = I.wave >> 1; bf16x8 If;
    { const int jj = 16 * (I.wave & 1) + fr - 8 * fq;
#pragma unroll
        for (int q = 0; q < 8; ++q) If[q] = (q == jj) ? (short)0x3F80 : (short)0; }
#pragma unroll
    for (int d = 0; d < 2; ++d) {
#pragma unroll
        for (int wh = 0; wh < 2; ++wh)
#pragma unroll
            for (int ks = 0; ks < 4; ++ks) Bf[d][wh][ks] = *(const GAS bf16x8*)(WT + (size_t)((d * 2 + wh) * 8 + hd) * 16384 + jc * 128 + 32 * ks + 8 * fq);
        const int ch = d * 1024 + hd * 128 + jc; nA[d] = -LOG2E * ba[ch]; nX[d] = -LOG2E * bx[ch];
        const float nl = -lam[ch]; cc[d] = (-8.0f * LOG2E) * ((nl > 0.f ? nl : 0.f) + log1pf(__expf(-fabsf(nl))));
#pragma unroll
        for (int k = 0; k < 4; ++k) { cwv[d][k][0] = cw[(size_t)(d * 4 + k) * 1024 + hd * 128 + 2 * cp]; cwv[d][k][1] = cw[(size_t)(d * 4 + k) * 1024 + hd * 128 + 2 * cp + 1]; }
        cbv[d][0] = cb[d * 1024 + hd * 128 + 2 * cp]; cbv[d][1] = cb[d * 1024 + hd * 128 + 2 * cp + 1]; }
    auto tile_load = [&](int un) { const int t0n = ((un < 8 * NCHUNK ? un : bid) >> 3) * TCH;
#pragma unroll
        for (int e = 0; e < 3; ++e) { const int q = I.tid + e * NWAVES * 64, row = q >> 4, c16 = q & 15, t = t0n - 3 + row;
            xpre[e] = (v4u){0u, 0u, 0u, 0u}; if (q < 70 * 16 && t >= 0 && t < S) xpre[e] = *(const GAS v4u*)(U + (size_t)t * DIN + U_LX + 128 * hd + 8 * c16); } };
    auto tile_put = [&](int b) {
#pragma unroll
        for (int e = 0; e < 3; ++e) { const int q = I.tid + e * NWAVES * 64; if (q < 70 * 16) *(LAS v4u*)(lds + L1_XR + b * L1_XRB + q * 16) = xpre[e]; } };
    auto conv_step = [&](int b) { const LAS unsigned char* XR = lds + L1_XR + b * L1_XRB; LAS unsigned char* X0 = lds + L1_XCB + (2 * b) * L1_XCBB; LAS unsigned char* X1 = X0 + L1_XCBB;
        float x0[14], x1[14];
#pragma unroll
        for (int r = 0; r < 14; ++r) { const unsigned v = *(const LAS unsigned*)(XR + (8 * tg + r) * 256 + cp * 4); x0[r] = bflo(v); x1[r] = bfhi(v); }
#pragma unroll
        for (int i = 0; i < 8; ++i) { const int tl = 8 * tg + i, R = 16 * ((tl >> 2) & 3) + 4 * (tl >> 4) + (tl & 3);
            float f0 = cbv[0][0], f1 = cbv[0][1], b0 = cbv[1][0], b1 = cbv[1][1];
#pragma unroll
            for (int k = 0; k < 4; ++k) { f0 += cwv[0][k][0] * x0[i + k]; f1 += cwv[0][k][1] * x1[i + k]; b0 += cwv[1][k][0] * x0[i + 6 - k]; b1 += cwv[1][k][1] * x1[i + 6 - k]; }
            *(LAS unsigned*)(X0 + R * 272 + cp * 4) = pk2(f0, f1); *(LAS unsigned*)(X1 + R * 272 + cp * 4) = pk2(b0, b1); } };
    tile_load(bid); tile_put(0);
    tile_load(bid + I.G);
    __syncthreads();
    conv_step(0);
    tile_put(1);
#pragma unroll
    for (int d = 0; d < 2; ++d) {
#pragma unroll
        for (int k = 0; k < 4; ++k) { asm volatile("" : "+v"(cwv[d][k][0]), "+v"(cwv[d][k][1])); asm volatile("" : "+v"(Bf[d][k >> 1][(k & 1) * 2]), "+v"(Bf[d][k >> 1][(k & 1) * 2 + 1])); }
        asm volatile("" : "+v"(cbv[d][0]), "+v"(cbv[d][1])); }
    int n = 0;
    for (int u = bid; u < 8 * NCHUNK; u += I.G, ++n) { const int ck = u >> 3, b = n & 1;
        __syncthreads();
        tile_load(u + 2 * I.G);
#pragma unroll
        for (int d = 0; d < 2; ++d) { const LAS unsigned char* XCB = lds + L1_XCB + (2 * b + d) * L1_XCBB;
            pg8::f32x4 accG[2][4], accX[4];
#pragma unroll
            for (int mt = 0; mt < 4; ++mt) { accG[0][mt] = (pg8::f32x4){0.f, 0.f, 0.f, 0.f}; accG[1][mt] = accG[0][mt];
#pragma unroll
                for (int ks = 0; ks < 4; ++ks) { const bf16x8 a = *(const LAS bf16x8*)(XCB + (16 * mt + fr) * 272 + ks * 64 + fq * 16);
                    accG[0][mt] = __builtin_amdgcn_mfma_f32_16x16x32_bf16(a, Bf[d][0][ks], accG[0][mt], 0, 0, 0); accG[1][mt] = __builtin_amdgcn_mfma_f32_16x16x32_bf16(a, Bf[d][1][ks], accG[1][mt], 0, 0, 0); }
                { const bf16x8 a = *(const LAS bf16x8*)(XCB + (16 * mt + fr) * 272 + ksel * 64 + fq * 16);
                    accX[mt] = __builtin_amdgcn_mfma_f32_16x16x32_bf16(a, If, (pg8::f32x4){0.f, 0.f, 0.f, 0.f}, 0, 0, 0); } }
            if (d == 0) {
                if (u + I.G < 8 * NCHUNK) conv_step(b ^ 1);
                __builtin_amdgcn_sched_barrier(0);
                tile_put(b);
                __builtin_amdgcn_sched_barrier(0); }
            float av[16], bv[16];
            const f32x2 nA2 = (f32x2){nA[d], nA[d]}, nX2 = (f32x2){nX[d], nX[d]};
#pragma unroll
            for (int kq = 0; kq < 4; ++kq) { v4u pk;
#pragma unroll
                for (int h = 0; h < 2; ++h) {
                    const f32x2 pa = (f32x2){accG[0][kq][2 * h], accG[0][kq][2 * h + 1]}, px = (f32x2){accG[1][kq][2 * h], accG[1][kq][2 * h + 1]}, xc = (f32x2){accX[kq][2 * h], accX[kq][2 * h + 1]};
                    const f32x2 ta = pa * -LOG2E + nA2, tx = px * -LOG2E + nX2;
                    f32x2 ea, ex; ea.x = __builtin_amdgcn_exp2f(ta.x); ea.y = __builtin_amdgcn_exp2f(ta.y); ex.x = __builtin_amdgcn_exp2f(tx.x); ex.y = __builtin_amdgcn_exp2f(tx.y);
                    const f32x2 da = ea + 1.0f, dx = ex + 1.0f;
                    f32x2 r, ig; r.x = __builtin_amdgcn_rcpf(da.x); r.y = __builtin_amdgcn_rcpf(da.y); ig.x = __builtin_amdgcn_rcpf(dx.x); ig.y = __builtin_amdgcn_rcpf(dx.y);
                    const f32x2 la = r * cc[d];
                    f32x2 aa; aa.x = __builtin_amdgcn_exp2f(la.x); aa.y = __builtin_amdgcn_exp2f(la.y);
                    const f32x2 dq = 1.0f - aa;
                    f32x2 dd; dd.x = h2lo(pk_h2(dq.x, 0.f)); dd.y = h2lo(pk_h2(dq.y, 0.f));
                    const f32x2 a_ = 1.0f - dd, sarg = dd * (a_ + 1.0f);
                    f32x2 sq; sq.x = __builtin_amdgcn_sqrtf(sarg.x); sq.y = __builtin_amdgcn_sqrtf(sarg.y);
                    const f32x2 bb = sq * (ig * xc);
                    const unsigned w0 = pk_h2(dd.x, bb.x), w1 = pk_h2(dd.y, bb.y);
                    pk[2 * h] = w0; pk[2 * h + 1] = w1; const int k = 4 * kq + 2 * h;
                    av[k] = a_.x; av[k + 1] = a_.y; bv[k] = h2hi(w0); bv[k + 1] = h2hi(w1); }
                LAB[((size_t)(u * 2 + d) * 4 + kq) * (NWAVES * 64) + I.tid] = pk; }
            float P = 1.f, H = 0.f;
#pragma unroll
            for (int s2 = 0; s2 < 16; ++s2) { const int k = d ? 15 - s2 : s2; H = av[k] * H + bv[k]; P *= av[k]; }
            float Pq[4], Hq[4];
#pragma unroll
            for (int q = 0; q < 4; ++q) { Pq[q] = __shfl(P, fr + 16 * q); Hq[q] = __shfl(H, fr + 16 * q); }
            float c = 0.f;
#pragma unroll
            for (int s2 = 0; s2 < 4; ++s2) { const int q = d ? 3 - s2 : s2; c = Pq[q] * c + Hq[q]; }
            if (fq == 0) *(GAS f32x2v*)(AGG + ((size_t)(d * NCHUNK + ck) * 1024 + hd * 128 + jc) * 2) = (f32x2v){(Pq[0] * Pq[1]) * (Pq[2] * Pq[3]), c};
        }
    }
    __syncthreads();
}
__device__ __forceinline__ void lru_pass2(unsigned char* w, LAS unsigned char* lds, int l, const Ids& I) {
    const bf16* U = (const bf16*)(w + WS_U); bf16* Y = (bf16*)(w + WS_Y); const float* AGG = (const float*)(w + WS_AGG); const GAS v4u* LAB = (const GAS v4u*)(w + WS_LAB);
    const int bid = I.gw / NWAVES, fr = I.lane & 15, fq = I.lane >> 4, jc = 16 * I.wave + fr, cp = I.tid & 63, tg = I.tid >> 6;
    LAS float* CS = (LAS float*)(lds + LR_CS);
    v4u pre[2][4];
    if (bid < 8 * NCHUNK) {
#pragma unroll
        for (int d = 0; d < 2; ++d)
#pragma unroll
            for (int kq = 0; kq < 4; ++kq) pre[d][kq] = LAB[((size_t)(bid * 2 + d) * 4 + kq) * (NWAVES * 64) + I.tid]; }
    {
        const int ch = I.tid & 127, sg = I.tid >> 7, k0 = bid >> 3, hd0 = bid & 7;
        const float* ag = AGG + ((size_t)(32 * sg) * 1024 + hd0 * 128 + ch) * 2;
        float Pp = 1.f, Hp = 0.f, Pf = 1.f, Hf = 0.f, Qp = 1.f, Gp = 0.f, Qf = 1.f, Gf = 0.f;
        f32x2v pf[32], pb[32];
#pragma unroll
        for (int k = 0; k < 32; ++k) pf[k] = *(const GAS f32x2v*)(ag + (size_t)k * 2048);
#pragma unroll
        for (int k = 0; k < 32; ++k) pb[k] = *(const GAS f32x2v*)(ag + (size_t)(NCHUNK * 1024) * 2 + (size_t)k * 2048);
#pragma unroll
        for (int k = 0; k < 32; ++k) { const f32x2v ph = pf[k]; if (k == k0) { Pp = Pf; Hp = Hf; } Hf = ph.x * Hf + ph.y; Pf = ph.x * Pf; }
#pragma unroll
        for (int kk = 31; kk >= 0; --kk) { const f32x2v ph = pb[kk]; if (kk == k0) { Qp = Qf; Gp = Gf; } Gf = ph.x * Gf + ph.y; Qf = ph.x * Qf; }
        LAS float* o = CS + (sg * 128 + ch) * 8; o[0] = Pp; o[1] = Hp; o[2] = Pf; o[3] = Hf; o[4] = Qp; o[5] = Gp; o[6] = Qf; o[7] = Gf;
        __syncthreads();
    }
    int par = 0;
    for (int u = bid; u < 8 * NCHUNK; u += I.G, par ^= 1) { const int hd = u & 7, ck = u >> 3, t0 = ck * TCH;
        v4u cur[2][4];
#pragma unroll
        for (int d = 0; d < 2; ++d)
#pragma unroll
            for (int kq = 0; kq < 4; ++kq) cur[d][kq] = pre[d][kq];
        { const int un = u + I.G;
            if (un < 8 * NCHUNK) {
#pragma unroll
                for (int d = 0; d < 2; ++d)
#pragma unroll
                    for (int kq = 0; kq < 4; ++kq) pre[d][kq] = LAB[((size_t)(un * 2 + d) * 4 + kq) * (NWAVES * 64) + I.tid]; } }
        unsigned gpre[8];
#pragma unroll
        for (int i = 0; i < 8; ++i) gpre[i] = *(const GAS unsigned*)(U + (size_t)(t0 + tg + 8 * i) * DIN + U_LG + 128 * hd + 2 * cp);
        float cin[2];
        { const int ui = ck >> 5; float c = 0.f;
#pragma unroll
            for (int s2 = 0; s2 < 4; ++s2) { const LAS float* o = CS + (s2 * 128 + jc) * 8; if (s2 < ui) c = o[2] * c + o[3]; }
            { const LAS float* o = CS + (ui * 128 + jc) * 8; cin[0] = o[0] * c + o[1]; }
            c = 0.f;
#pragma unroll
            for (int s2 = 3; s2 >= 0; --s2) { const LAS float* o = CS + (s2 * 128 + jc) * 8; if (s2 > ui) c = o[6] * c + o[7]; }
            { const LAS float* o = CS + (ui * 128 + jc) * 8; cin[1] = o[4] * c + o[5]; } }
        float hsum[16];
#pragma unroll
        for (int k = 0; k < 16; ++k) hsum[k] = 0.f;
#pragma unroll
        for (int d = 0; d < 2; ++d) {
            float av[16], bv[16];
#pragma unroll
            for (int k = 0; k < 16; ++k) { const unsigned wv = cur[d][k >> 2][k & 3]; av[k] = 1.0f - h2lo(wv); bv[k] = h2hi(wv); }
            float P = 1.f, H = 0.f;
#pragma unroll
            for (int s = 0; s < 16; ++s) { const int k = d ? 15 - s : s; H = av[k] * H + bv[k]; P *= av[k]; }
            float Pq[4], Hq[4];
#pragma unroll
            for (int q = 0; q < 4; ++q) { Pq[q] = __shfl(P, fr + 16 * q); Hq[q] = __shfl(H, fr + 16 * q); }
            float c = cin[d], mine = 0.f;
#pragma unroll
            for (int s = 0; s < 4; ++s) { const int q = d ? 3 - s : s; mine = (q == fq) ? c : mine; c = Pq[q] * c + Hq[q]; }
            float Hh = mine;
#pragma unroll
            for (int s = 0; s < 16; ++s) { const int k = d ? 15 - s : s; Hh = av[k] * Hh + bv[k]; hsum[k] += Hh; }
        }
        LAS float* HO = (LAS float*)(lds + (par ? LR_HO1 : LR_HO0));
#pragma unroll
        for (int k = 0; k < 16; ++k) HO[(16 * fq + k) * 129 + jc] = hsum[k];
        __syncthreads();
#pragma unroll
        for (int i = 0; i < 8; ++i) { const int tl = tg + 8 * i; const float h0 = HO[tl * 129 + 2 * cp], h1 = HO[tl * 129 + 2 * cp + 1]; const unsigned gg = gpre[i];
            *(GAS unsigned*)(Y + (size_t)(t0 + tl) * D + 1024 + 128 * hd + 2 * cp) = pk2(h0 * gelu_tanh_f(bflo(gg)), h1 * gelu_tanh_f(bfhi(gg))); }
    }
    __syncthreads();
}
__device__ __forceinline__ void ph_mixA(unsigned char* w, LAS unsigned char* lds, int l) {
    const Ids I = make_ids();
    conv_units(w, lds, l, I);
    pool_units(w, lds, l, I);
    lru_pass1(w, lds, l, I);
}
__device__ __forceinline__ void ph_mixB(unsigned char* w, LAS unsigned char* lds, int l) {
    const Ids I = make_ids();
    lru_pass2(w, lds, l, I);
}

__global__ void __launch_bounds__(NWAVES * 64, 2) mk_fwd(Args args) {
    extern __shared__ __attribute__((aligned(16))) unsigned char lds_raw[];
    LAS unsigned char* lds = (LAS unsigned char*)lds_raw;
    for (int u = threadIdx.x; u < (LDS_BYTES - LDSCTL_OFF) / 4; u += NWAVES * 64) ((LAS unsigned*)(lds + LDSCTL_OFF))[u] = 0u;
    __syncthreads();
    (void)xcd_barrier_post((unsigned*)(args.ws + WS_CTL) + CW_BAR, (volatile LAS unsigned*)(lds + MISC_OFF) + 8);

    int p = 0; const int lo = args.ph_lo, hi = args.ph_hi;
#define PH_ON (p >= lo && p < hi)
#define WSO(w) unsigned char* w = opaque_ptr(args.ws)
#define PH_END do { if (p >= lo && p + 1 < hi) { WSO(wb_); grid_sync(wb_, lds); } ++p; } while (0)

    if (PH_ON) ph_prologue(args, lds);
    PH_END;
#pragma nounroll
    for (int i = 0; i < 2 * DEPTH; ++i) {
        const int l = i >> 1, f = i & 1;
        if (PH_ON) { WSO(w); ph_gateup(w, lds, l, f); }
        PH_END;
        if (PH_ON) { WSO(w); ph_down(w, lds, l, f); }
        PH_END;
        if (f == 0) {
            if (PH_ON) { WSO(w); ph_win(w, lds, l); }
            PH_END;
            if (PH_ON) { WSO(w); ph_mixA(w, lds, l); }
            PH_END;
            if (PH_ON) { WSO(w); ph_mixB(w, lds, l); }
            PH_END;
            if (PH_ON) { WSO(w); ph_wout(w, lds, l); }
            PH_END;
        }
    }
    if (PH_ON) { WSO(w); ph_final(w); }
#undef PH_ON
#undef PH_END
#undef WSO
}

#ifndef MK_SPLIT
#define MK_SPLIT 0
#endif
constexpr int N_PHASES = 1 + DEPTH * (2 + 2 + 4) + 1;
extern "C" void kernel_launch(void* const* d_in, const int* in_sizes, int n_in, void* d_out, int out_size, void* d_ws, size_t ws_size, hipStream_t stream) {
    static int grid = 0;
    if (grid == 0) {
        if (n_in != 26 || in_sizes[0] != S * D || out_size != S * D || ws_size < WS_END) { fprintf(stderr, "kernel_launch: unexpected shapes (n_in %d, in0 %d, out %d, ws %zu < %zu); nothing launched\n", n_in, n_in > 0 ? in_sizes[0] : -1, out_size, ws_size, (size_t)WS_END); grid = -1; return; }
        int dev = 0, cus = 0, per_cu = 0;
        if (hipGetDevice(&dev) != hipSuccess || hipDeviceGetAttribute(&cus, hipDeviceAttributeMultiprocessorCount, dev) != hipSuccess) { fprintf(stderr, "kernel_launch: device query failed\n"); grid = -1; return; }
        if (hipFuncSetAttribute((const void*)mk_fwd, hipFuncAttributeMaxDynamicSharedMemorySize, LDS_BYTES) != hipSuccess) { fprintf(stderr, "kernel_launch: hipFuncSetAttribute failed\n"); grid = -1; return; }
        if (hipOccupancyMaxActiveBlocksPerMultiprocessor(&per_cu, (const void*)mk_fwd, NWAVES * 64, LDS_BYTES) != hipSuccess || per_cu < 1) fprintf(stderr, "kernel_launch: note: occupancy query reports %d workgroups per CU\n", per_cu);
        (void)hipGetLastError();
        grid = cus;
        if (grid != 256) fprintf(stderr, "kernel_launch: %d CUs; the residual GEMM phases need exactly 256 workgroups\n", grid);
    }
    if (grid < 0) return;
    if (hipMemsetAsync((char*)d_ws + WS_CTL, 0, CTL_ZERO_BYTES, stream) != hipSuccess) { fprintf(stderr, "kernel_launch: hipMemsetAsync failed\n"); return; }
    Args a{};
    for (int i = 0; i < 26; ++i) a.in[i] = (const float*)d_in[i];
    a.out = (float*)d_out; a.ws = (unsigned char*)d_ws;
#if MK_SPLIT
    for (int ph = 0; ph < N_PHASES; ++ph) { a.ph_lo = ph; a.ph_hi = ph + 1; hipLaunchKernelGGL(mk_fwd, dim3(grid), dim3(NWAVES * 64), LDS_BYTES, stream, a); }
#else
    a.ph_lo = 0; a.ph_hi = 1 << 30;
    hipLaunchKernelGGL(mk_fwd, dim3(grid), dim3(NWAVES * 64), LDS_BYTES, stream, a);
#endif
    const hipError_t le = hipPeekAtLastError();
    if (le != hipSuccess) fprintf(stderr, "kernel_launch: launch failed: %s\n", hipGetErrorName(le));
}
```
